# Optimizing an MI355X kernel written in HIP

```python
import jax, jax.numpy as jnp
from jax import lax
import numpy as np

D_MODEL = 1024
BATCH = 4
SEQ = 4096
DEPTH = 4

D_PLE = 256
M_HEADS = 4
M_HEAD_DIM = 128
M_WIDTH = M_HEADS * M_HEAD_DIM
M_CONV = 5
M_CHUNK = 64
N_GATE = 4 * M_HEADS
A_HEADS = 8
A_KV_HEADS = 2
A_HEAD_DIM = 64
A_WIDTH = A_HEADS * A_HEAD_DIM
A_KV_WIDTH = A_KV_HEADS * A_HEAD_DIM
A_GROUP = A_HEADS // A_KV_HEADS
WINDOW = 128
A_BLOCK = 128
MIX_WIDTH = M_WIDTH + A_WIDTH
IN_WIDTH = 4 * M_WIDTH + N_GATE + A_WIDTH + 2 * A_KV_WIDTH
D_FF = ((-(-8 * D_MODEL // 3) + 255) // 256) * 256
ALPHA = (2 * DEPTH) ** 0.25
BETA = (8 * DEPTH) ** -0.25
LN_EPS = 1e-5
MH_EPS = 1e-6

kernel_name = "hybrid_mlstm_swa_deepnorm_encoder"


def _layer_norm(x, g, b):
    xf = x.astype(jnp.float32)
    mu = xf.mean(-1, keepdims=True)
    var = jnp.mean(jnp.square(xf - mu), -1, keepdims=True)
    return ((xf - mu) * lax.rsqrt(var + LN_EPS) * g + b).astype(x.dtype)


def _centred_dwconv(x, w, b):
    pad = w.shape[0] // 2
    y = lax.conv_general_dilated(x, w[:, None, :], window_strides=(1,), padding=[(pad, pad)],
                                 dimension_numbers=("NWC", "WIO", "NWC"),
                                 feature_group_count=x.shape[-1])
    return y + b


def _mlstm_scan(q, k, v, i_pre, log_f):
    B, H, S, dh = q.shape
    L = M_CHUNK
    nc = S // L

    def chunks(t):
        return jnp.moveaxis(t.reshape(B, H, nc, L, *t.shape[3:]), 2, 0)

    lower = jnp.tril(jnp.ones((L, L), dtype=bool))

    def step(carry, xs):
        C, n, m = carry
        qc, kc, vc, ic, fc = xs
        b = jnp.cumsum(fc, axis=-1)
        dmat = b[..., :, None] - b[..., None, :] + ic[..., None, :]
        dmat = jnp.where(lower, dmat, -jnp.inf)
        inter = b + m[..., None]
        m_t = jnp.maximum(dmat.max(-1), inter)
        w_intra = jnp.exp(dmat - m_t[..., None])
        w_inter = jnp.exp(inter - m_t)
        s = jnp.einsum('bhtd,bhsd->bhts', qc, kc) * w_intra
        num = jnp.einsum('bhts,bhse->bhte', s, vc) + w_inter[..., None] * jnp.einsum('bhed,bhtd->bhte', C, qc)
        den = s.sum(-1) + w_inter * jnp.einsum('bhd,bhtd->bht', n, qc)
        h = num / jnp.maximum(jnp.abs(den), jnp.exp(-m_t))[..., None]
        g = b[..., -1]
        a = g[..., None] - b + ic
        m_new = jnp.maximum(g + m, a.max(-1))
        decay = jnp.exp(g + m - m_new)
        wa = jnp.exp(a - m_new[..., None])
        C = decay[..., None, None] * C + jnp.einsum('bhs,bhse,bhsd->bhed', wa, vc, kc)
        n = decay[..., None] * n + jnp.einsum('bhs,bhsd->bhd', wa, kc)
        return (C, n, m_new), h

    init = (jnp.zeros((B, H, dh, dh), jnp.float32), jnp.zeros((B, H, dh), jnp.float32),
            jnp.zeros((B, H), jnp.float32))
    _, h = lax.scan(step, init, (chunks(q), chunks(k), chunks(v), chunks(i_pre), chunks(log_f)))
    return jnp.moveaxis(h, 0, 2).reshape(B, H, S, dh)


def _mlstm_group(qk, v, o, gates, b_gate, conv_w, conv_b, norm_g):
    B, S, _ = v.shape
    qk = jax.nn.silu(_centred_dwconv(qk, conv_w, conv_b))
    q, k = jnp.split(qk, 2, axis=-1)

    def to_heads(t):
        return t.reshape(B, S, M_HEADS, M_HEAD_DIM).transpose(0, 2, 1, 3).astype(jnp.float32)

    q, k, vh = to_heads(q), to_heads(k) * (M_HEAD_DIM ** -0.5), to_heads(v)
    g = (gates + b_gate).astype(jnp.float32).reshape(B, S, 4, M_HEADS).transpose(2, 0, 3, 1)
    h_fwd = _mlstm_scan(q, k, vh, g[0], jax.nn.log_sigmoid(g[2]))

    def flip(t):
        return jnp.flip(t, axis=2)

    h_bwd = flip(_mlstm_scan(flip(q), flip(k), flip(vh), flip(g[1]), flip(jax.nn.log_sigmoid(g[3]))))
    h = h_fwd + h_bwd
    mu = h.mean(-1, keepdims=True)
    var = jnp.mean(jnp.square(h - mu), -1, keepdims=True)
    h = ((h - mu) * lax.rsqrt(var + MH_EPS)).transpose(0, 2, 1, 3).reshape(B, S, M_WIDTH)
    return (h * norm_g * jax.nn.sigmoid(o.astype(jnp.float32))).astype(v.dtype)


def _window_gqa(q, k, v, sink):
    B, S, _ = q.shape
    nb = S // A_BLOCK
    qb = q.reshape(B, nb, A_BLOCK, A_KV_HEADS, A_GROUP, A_HEAD_DIM)

    def band(t):
        t = t.reshape(B, nb, A_BLOCK, A_KV_HEADS, A_HEAD_DIM)
        t = jnp.pad(t, ((0, 0), (1, 1), (0, 0), (0, 0), (0, 0)))
        return jnp.concatenate([t[:, :-2], t[:, 1:-1], t[:, 2:]], axis=2)

    kb, vb = band(k), band(v)
    s = jnp.einsum('bnqhgd,bnkhd->bnhgqk', qb, kb).astype(jnp.float32) * (A_HEAD_DIM ** -0.5)
    blk = jnp.arange(nb)[:, None]
    qpos = blk * A_BLOCK + jnp.arange(A_BLOCK)[None]
    kpos = (blk - 1) * A_BLOCK + jnp.arange(3 * A_BLOCK)[None]
    rel = jnp.abs(kpos[:, None, :] - qpos[:, :, None])
    valid = (rel <= WINDOW) & (kpos[:, None, :] >= 0) & (kpos[:, None, :] < S)
    slopes = jnp.exp2(-8.0 * jnp.arange(1, A_HEADS + 1, dtype=jnp.float32) / A_HEADS)
    bias = -slopes.reshape(A_KV_HEADS, A_GROUP)[None, :, :, None, None] * rel[:, None, None].astype(jnp.float32)
    s = jnp.where(valid[:, None, None], s + bias, -jnp.inf)
    sk = sink.astype(jnp.float32).reshape(A_KV_HEADS, A_GROUP)[None, None, :, :, None, None]
    mx = jnp.maximum(s.max(-1, keepdims=True), sk)
    e = jnp.exp(s - mx)
    prob = e / (e.sum(-1, keepdims=True) + jnp.exp(sk - mx))
    out = jnp.einsum('bnhgqk,bnkhd->bnqhgd', prob.astype(v.dtype), vb)
    return out.reshape(B, S, A_WIDTH)


def _hybrid_layer(x, p_i, w_in, b_gate, conv_w, conv_b, mlstm_norm_g, attn_sink, w_out,
                  ln1_g, ln1_b, w_ffn_in, w_ffn_out, ln2_g, ln2_b, w_ple_gate, w_ple_proj):
    u = x @ w_in
    cuts = np.cumsum([2 * M_WIDTH, M_WIDTH, M_WIDTH, N_GATE, A_WIDTH, A_KV_WIDTH]).tolist()
    m_qk, m_v, m_o, m_gates, a_q, a_k, a_v = jnp.split(u, cuts, axis=-1)
    h_m = _mlstm_group(m_qk, m_v, m_o, m_gates, b_gate, conv_w, conv_b, mlstm_norm_g)
    h_a = _window_gqa(a_q, a_k, a_v, attn_sink)
    mix = jnp.concatenate([h_m, h_a], axis=-1) @ w_out
    x = _layer_norm(ALPHA * x + mix, ln1_g, ln1_b)
    gate_ff, up_ff = jnp.split(x @ w_ffn_in, 2, axis=-1)
    ffn = (jax.nn.silu(gate_ff) * up_ff) @ w_ffn_out
    ple = jax.nn.sigmoid(x @ w_ple_gate) * (p_i @ w_ple_proj)
    return _layer_norm(ALPHA * x + ffn + ple, ln2_g, ln2_b)


def setup_inputs(seed: int = 0) -> dict:
    key = jax.random.key(seed)
    ks = jax.random.split(key, 20)
    nrm = lambda k, shape: jax.random.normal(k, shape, jnp.float32)
    col_scale = np.ones((IN_WIDTH,), np.float32)
    col_scale[3 * M_WIDTH - M_WIDTH:3 * M_WIDTH] = BETA
    av0 = 4 * M_WIDTH + N_GATE + A_WIDTH + A_KV_WIDTH
    col_scale[av0:av0 + A_KV_WIDTH] = BETA
    w_in = nrm(ks[2], (DEPTH, D_MODEL, IN_WIDTH)) * (D_MODEL ** -0.5) * jnp.asarray(col_scale)
    f_lin = jnp.linspace(3.0, 6.0, M_HEADS, dtype=jnp.float32)
    b_gate = jnp.concatenate([0.1 * nrm(ks[3], (DEPTH, 2 * M_HEADS)),
                              jnp.concatenate([f_lin, f_lin])[None] + 0.1 * nrm(ks[4], (DEPTH, 2 * M_HEADS))], axis=-1)
    return {
        "x": nrm(ks[0], (BATCH, SEQ, D_MODEL)),
        "p": nrm(ks[1], (DEPTH, BATCH, SEQ, D_PLE)),
        "w_in": w_in,
        "b_gate": b_gate,
        "conv_w": nrm(ks[5], (DEPTH, M_CONV, 2 * M_WIDTH)) * (M_CONV ** -0.5),
        "conv_b": 0.01 * nrm(ks[6], (DEPTH, 2 * M_WIDTH)),
        "mlstm_norm_g": 1.0 + 0.01 * nrm(ks[7], (DEPTH, M_WIDTH)),
        "attn_sink": 0.5 * nrm(ks[8], (DEPTH, A_HEADS)),
        "w_out": nrm(ks[9], (DEPTH, MIX_WIDTH, D_MODEL)) * (MIX_WIDTH ** -0.5) * BETA,
        "ln1_g": 1.0 + 0.01 * nrm(ks[10], (DEPTH, D_MODEL)),
        "ln1_b": 0.01 * nrm(ks[11], (DEPTH, D_MODEL)),
        "w_ffn_in": nrm(ks[12], (DEPTH, D_MODEL, 2 * D_FF)) * (D_MODEL ** -0.5) * BETA,
        "w_ffn_out": nrm(ks[13], (DEPTH, D_FF, D_MODEL)) * (D_FF ** -0.5) * BETA,
        "ln2_g": 1.0 + 0.01 * nrm(ks[14], (DEPTH, D_MODEL)),
        "ln2_b": 0.01 * nrm(ks[15], (DEPTH, D_MODEL)),
        "w_ple_gate": nrm(ks[16], (DEPTH, D_MODEL, D_MODEL)) * (D_MODEL ** -0.5),
        "w_ple_proj": nrm(ks[17], (DEPTH, D_PLE, D_MODEL)) * (D_PLE ** -0.5) * BETA,
    }


def reference(x, p, w_in, b_gate, conv_w, conv_b, mlstm_norm_g, attn_sink, w_out,
              ln1_g, ln1_b, w_ffn_in, w_ffn_out, ln2_g, ln2_b, w_ple_gate, w_ple_proj):
    h = x
    for i in range(DEPTH):
        h = _hybrid_layer(h, p[i], w_in[i], b_gate[i], conv_w[i], conv_b[i], mlstm_norm_g[i],
                          attn_sink[i], w_out[i], ln1_g[i], ln1_b[i], w_ffn_in[i], w_ffn_out[i],
                          ln2_g[i], ln2_b[i], w_ple_gate[i], w_ple_proj[i])
    return h
```

```cpp
#include <hip/hip_runtime.h>
#include <hip/hip_cooperative_groups.h>
#include <cstdint>
#include <cstdio>
namespace cg = cooperative_groups;
#define ONE_LAUNCH 0
namespace pg8 {
#define PG8_LAS __attribute__((address_space(3)))
typedef unsigned short bf16_t;
typedef short bf16x8 __attribute__((ext_vector_type(8)));
typedef float f32x4 __attribute__((ext_vector_type(4)));
typedef unsigned u32x4 __attribute__((ext_vector_type(4)));
constexpr int BM = 256, BK = 64, HALF = 128, HTB = HALF * BK * 2  , STAGE_BYTES = 8 * HTB, NXCD = 8, WGM = 8;

__host__ __device__ __forceinline__ int lds_byte(int r, int c) { const int st = (r >> 4) * 2 + (c >> 5), rr = r & 15, cc = c & 31, ob = rr * 64 + cc * 2; return st * 1024 + (ob ^ (((ob >> 9) & 1) << 5)); }
__host__ __device__ __forceinline__ void stage_rc(int b, int& R, int& C) { const int st = b / 1024, sb = b % 1024, swz = sb ^ (((sb >> 9) & 1) << 5); R = (st >> 1) * 16 + swz / 64; C = (st & 1) * 32 + (swz % 64) / 2; }
__host__ __device__ __forceinline__ int perm32(int rho) { const int n = rho >> 4, i = rho & 15; return 8 * (i >> 2) + 4 * n + (i & 3); }

struct Unit { int pm, pn; };
struct Gemm { const bf16_t* A; const bf16_t* Bt; int M, N, K; };

struct StaticOrder {
    int nM, nN, nwg, G, c;
    __host__ __device__ void init(int M, int N, int G_, int c_) { nM = M / BM; nN = N / BM; nwg = nM * nN; G = G_; c = c_; }
    __host__ __device__ bool next(int i, Unit& u) const {
        const long L = (long)i * G + c; if (L >= nwg) return false;
        int wgid = (int)L; { const int q = nwg / NXCD, r = nwg % NXCD, xcd = wgid % NXCD, off = wgid / NXCD; wgid = (xcd < r ? xcd * (q + 1) : r * (q + 1) + (xcd - r) * q) + off; }
        const int nig = WGM * nN, gid = wgid / nig, fm = gid * WGM, gsz = (nM - fm) < WGM ? (nM - fm) : WGM;
        u.pm = fm + ((wgid % nig) % gsz); u.pn = (wgid % nig) / gsz; return true;
    }
    __device__ __forceinline__ void a_ready(const Unit&) const {}
    __device__ __forceinline__ void done(const Unit&) const {}
};
template <class Epi, class Sched, bool ALIGN_EPI = false, bool SP2 = false>
__device__ __forceinline__ void gemm_phase(PG8_LAS unsigned char* lds, const Gemm g, const Sched& S, const Epi& E) {
    int tid = threadIdx.x; asm volatile("" : "+v"(tid)); const int wid = __builtin_amdgcn_readfirstlane(tid >> 6), lane = tid & 63, wr = wid >> 2, wc = wid & 3, fr = lane & 15, fq = lane >> 4;
    const int K = g.K, nt = K / BK;
    unsigned voffA[2], voffB[2];
#pragma unroll
    for (int i = 0; i < 2; ++i) { int R, C; stage_rc(tid * 16 + i * 8192, R, C); const int Rb = Epi::PERM ? ((R & ~31) + perm32(R & 31)) : R;
        voffA[i] = (unsigned)(R * K + C) * 2u; voffB[i] = (unsigned)(Rb * K + C) * 2u; }
    const size_t kstep = (size_t)(BK * 2);
    const size_t hstep = (size_t)HALF * K * 2;
    const size_t tstep = 2 * hstep;
    const unsigned ldsw = (unsigned)wid * 1024u;
    const int aoff = lds_byte(wr * 64 + fr, fq * 8), boff = lds_byte(wc * 32 + fr, fq * 8);
#define PG8_SA(b, h) (((b) * 2 + (h)) * HTB)
#define PG8_SB(b, h) ((4 + (b) * 2 + (h)) * HTB)
#define PG8_STAGE(bufoff, gbase, voff) do { _Pragma("unroll") for (int _i = 0; _i < 2; ++_i) \
        __builtin_amdgcn_global_load_lds((const unsigned*)((const char*)(gbase) + (voff)[_i]), (PG8_LAS unsigned*)(lds + (bufoff) + ldsw + _i * 8192), 16, 0, 0); } while (0)
#define PG8_LDA(dst, b, h) do { _Pragma("unroll") for (int m = 0; m < 4; ++m) _Pragma("unroll") for (int k = 0; k < 2; ++k) dst[m][k] = *(const PG8_LAS bf16x8*)(lds + PG8_SA(b, h) + aoff + m * 2048 + k * 1024); } while (0)
#define PG8_LDB(dst, b, h) do { _Pragma("unroll") for (int n = 0; n < 2; ++n) _Pragma("unroll") for (int k = 0; k < 2; ++k) dst[n][k] = *(const PG8_LAS bf16x8*)(lds + PG8_SB(b, h) + boff + n * 2048 + k * 1024); } while (0)
#define PG8_MMA(ai, bj, At, Bt) do { __builtin_amdgcn_s_setprio(1); _Pragma("unroll") for (int m = 0; m < 4; ++m) _Pragma("unroll") for (int n = 0; n < 2; ++n) _Pragma("unroll") for (int k = 0; k < 2; ++k) \
        acc[ai][bj][m][n] = __builtin_amdgcn_mfma_f32_16x16x32_bf16(Bt[n][k], At[m][k], acc[ai][bj][m][n], 0, 0, 0); __builtin_amdgcn_s_setprio(0); } while (0)
#define PG8_WAIT_V(n) asm volatile("s_waitcnt vmcnt(" #n ")" ::: "memory")
#define PG8_WAIT_L(n) asm volatile("s_waitcnt lgkmcnt(" #n ")" ::: "memory")
#define PG8_BAR __builtin_amdgcn_s_barrier()
#define PG8_SCHED __builtin_amdgcn_sched_barrier(0)
    Unit cur, nxt; int ui = 0;
    if (!S.next(0, cur)) return;
    f32x4 acc[2][2][4][2];
#pragma unroll
    for (int a = 0; a < 2; ++a)
#pragma unroll
        for (int b = 0; b < 2; ++b)
#pragma unroll
            for (int m = 0; m < 4; ++m)
#pragma unroll
                for (int n = 0; n < 2; ++n) acc[a][b][m][n] = (f32x4){0.f, 0.f, 0.f, 0.f};
    bf16x8 At[4][2], B0[2][2], B1[2][2];
    const char* cA = (const char*)g.A + (size_t)cur.pm * tstep; const char* cB = (const char*)g.Bt + (size_t)cur.pn * tstep;
    S.a_ready(cur);
    if constexpr (SP2) {
        PG8_STAGE(PG8_SB(0, 0), cB, voffB); PG8_STAGE(PG8_SB(0, 1), cB + hstep, voffB); PG8_STAGE(PG8_SA(0, 0), cA, voffA); PG8_STAGE(PG8_SA(0, 1), cA + hstep, voffA);
        if (wr == 1) PG8_BAR;
        PG8_WAIT_V(2); PG8_BAR;
        PG8_STAGE(PG8_SB(1, 0), cB + kstep, voffB); PG8_STAGE(PG8_SA(1, 0), cA + kstep, voffA); PG8_STAGE(PG8_SB(1, 1), cB + hstep + kstep, voffB);
        PG8_WAIT_V(6); PG8_BAR;
    } else {
        PG8_STAGE(PG8_SB(0, 0), cB, voffB); PG8_STAGE(PG8_SA(0, 0), cA, voffA); PG8_STAGE(PG8_SB(0, 1), cB + hstep, voffB); PG8_STAGE(PG8_SA(0, 1), cA + hstep, voffA);
        if (wr == 1) PG8_BAR;
        PG8_WAIT_V(4); PG8_BAR;
        PG8_STAGE(PG8_SB(1, 0), cB + kstep, voffB); PG8_STAGE(PG8_SA(1, 0), cA + kstep, voffA); PG8_STAGE(PG8_SB(1, 1), cB + hstep + kstep, voffB);
        PG8_WAIT_V(6); PG8_BAR;
    }
    for (;;) {
        const bool has_next = S.next(ui + 1, nxt);
        const char* nA = has_next ? (const char*)g.A + (size_t)nxt.pm * tstep : cA; const char* nB = has_next ? (const char*)g.Bt + (size_t)nxt.pn * tstep : cB;
        for (int t = 0; t < nt; t += 2) {
            const bool last = (t == nt - 2);
            const char* a1 = cA + (size_t)(t + 1) * kstep;
            const char* a2 = last ? nA : cA + (size_t)(t + 2) * kstep; const char* b2 = last ? nB : cB + (size_t)(t + 2) * kstep;
            const char* a3 = a2 + kstep; const char* b3 = b2 + kstep;
            if (last && has_next) S.a_ready(nxt);
            if constexpr (SP2) {
            PG8_LDB(B0, 0, 0); PG8_LDB(B1, 0, 1); PG8_SCHED; PG8_LDA(At, 0, 0); PG8_STAGE(PG8_SA(1, 1), a1 + hstep, voffA);
            PG8_WAIT_V(8); PG8_WAIT_L(0); PG8_BAR; PG8_MMA(0, 0, At, B0); PG8_MMA(0, 1, At, B1); PG8_BAR; PG8_SCHED;
            PG8_LDA(At, 0, 1); PG8_STAGE(PG8_SB(0, 0), b2, voffB); PG8_STAGE(PG8_SB(0, 1), b2 + hstep, voffB); PG8_STAGE(PG8_SA(0, 0), a2, voffA);
            PG8_WAIT_V(8); PG8_WAIT_L(0); PG8_BAR; PG8_MMA(1, 0, At, B0); PG8_MMA(1, 1, At, B1); PG8_BAR; PG8_SCHED;
            PG8_LDB(B0, 1, 0); PG8_LDB(B1, 1, 1); PG8_SCHED; PG8_LDA(At, 1, 0); PG8_STAGE(PG8_SA(0, 1), a2 + hstep, voffA);
            PG8_WAIT_V(8); PG8_WAIT_L(0); PG8_BAR; PG8_MMA(0, 0, At, B0); PG8_MMA(0, 1, At, B1); PG8_BAR; PG8_SCHED;
            PG8_LDA(At, 1, 1); PG8_STAGE(PG8_SB(1, 0), b3, voffB); PG8_STAGE(PG8_SB(1, 1), b3 + hstep, voffB); PG8_STAGE(PG8_SA(1, 0), a3, voffA);
            PG8_WAIT_V(8); PG8_WAIT_L(0); PG8_BAR; PG8_MMA(1, 0, At, B0); PG8_MMA(1, 1, At, B1); PG8_BAR; PG8_SCHED;
            } else {
            PG8_LDB(B0, 0, 0); PG8_SCHED; PG8_LDA(At, 0, 0); PG8_STAGE(PG8_SA(1, 1), a1 + hstep, voffA);
            PG8_WAIT_L(8); PG8_BAR; PG8_WAIT_L(0); PG8_MMA(0, 0, At, B0); PG8_BAR; PG8_SCHED;
            PG8_LDB(B1, 0, 1); PG8_STAGE(PG8_SB(0, 0), b2, voffB);
            PG8_BAR; PG8_WAIT_L(0); PG8_MMA(0, 1, At, B1); PG8_BAR;
            PG8_LDA(At, 0, 1); PG8_STAGE(PG8_SA(0, 0), a2, voffA);
            PG8_BAR; PG8_WAIT_L(0); PG8_MMA(1, 0, At, B0); PG8_BAR; PG8_SCHED;
            PG8_STAGE(PG8_SB(0, 1), b2 + hstep, voffB);
            PG8_WAIT_V(6); PG8_BAR; PG8_MMA(1, 1, At, B1); PG8_BAR;
            PG8_LDB(B0, 1, 0); PG8_SCHED; PG8_LDA(At, 1, 0); PG8_STAGE(PG8_SA(0, 1), a2 + hstep, voffA);
            PG8_WAIT_L(8); PG8_BAR; PG8_WAIT_L(0); PG8_MMA(0, 0, At, B0); PG8_BAR; PG8_SCHED;
            PG8_LDB(B1, 1, 1); PG8_STAGE(PG8_SB(1, 0), b3, voffB);
            PG8_BAR; PG8_WAIT_L(0); PG8_MMA(0, 1, At, B1); PG8_BAR;
            PG8_LDA(At, 1, 1); PG8_STAGE(PG8_SA(1, 0), a3, voffA);
            PG8_BAR; PG8_WAIT_L(0); PG8_MMA(1, 0, At, B0); PG8_BAR; PG8_SCHED;
            PG8_STAGE(PG8_SB(1, 1), b3 + hstep, voffB);
            PG8_WAIT_V(6); PG8_BAR; PG8_MMA(1, 1, At, B1); PG8_BAR;
            }
        }
        if constexpr (ALIGN_EPI) { if (wr == 0) PG8_BAR; }
        if constexpr (!Epi::AFTER_DRAIN) { E(acc, cur, wr, wc, fr, fq); S.done(cur); }
        if (!has_next) break;
#pragma unroll
        for (int a = 0; a < 2; ++a)
#pragma unroll
            for (int b = 0; b < 2; ++b)
#pragma unroll
                for (int m = 0; m < 4; ++m)
#pragma unroll
                    for (int n = 0; n < 2; ++n) acc[a][b][m][n] = (f32x4){0.f, 0.f, 0.f, 0.f};
        cur = nxt; cA = nA; cB = nB; ++ui;
        if constexpr (ALIGN_EPI) { if (wr == 1) PG8_BAR; }
    }
    PG8_WAIT_V(0);
    if constexpr (!ALIGN_EPI) { if (wr == 0) PG8_BAR; }
    PG8_BAR;
    if constexpr (Epi::AFTER_DRAIN) { E.fused(acc, cur, wr, wc, fr, fq, lds, wid, lane); S.done(cur); }
#undef PG8_SA
#undef PG8_SB
#undef PG8_STAGE
#undef PG8_LDA
#undef PG8_LDB
#undef PG8_MMA
#undef PG8_WAIT_V
#undef PG8_WAIT_L
#undef PG8_BAR
#undef PG8_SCHED
}
}

#define LAS __attribute__((address_space(3)))
typedef unsigned short bf16_t;
typedef short bf16x8 __attribute__((ext_vector_type(8)));
typedef short s16x4 __attribute__((ext_vector_type(4)));
typedef float f32x4 __attribute__((ext_vector_type(4)));
typedef float f32x2 __attribute__((ext_vector_type(2)));
typedef unsigned u32x4 __attribute__((ext_vector_type(4)));
typedef unsigned u32x2 __attribute__((ext_vector_type(2)));
typedef __bf16 bf16x2_t __attribute__((ext_vector_type(2)));

#ifndef ONE_LAUNCH
#define ONE_LAUNCH 0
#endif
#ifndef STAGE_MASK
#define STAGE_MASK 0x7ff
#endif
#define ST_ON(k) ((STAGE_MASK >> (k)) & 1)

constexpr int NB = 4, SEQ = 4096, DM = 1024, MTOK = NB * SEQ, DEPTH = 4, DPLE = 256;
constexpr int NIN = 3072, NIN_SRC = 2832, DFF = 2816, NFFN = 6656;
constexpr int C_QK = 0, C_V = 1024, C_O = 1536, C_AQ = 2048, C_AK = 2560, C_AV = 2688, C_G = 2816;
constexpr int LCH = 128, NCH = SEQ / LCH, ST_E = 144, ST_TILE = ST_E * 128;
constexpr float ALPHA = 1.6817928305074292f;
constexpr float LN_EPS = 1e-5f, MH_EPS = 1e-6f;
constexpr int NSTAGE = 11;
constexpr int NPHASE = DEPTH * NSTAGE;
constexpr int NTHR = 512;

constexpr size_t MiB = 1u << 20;
constexpr size_t WS_CTL = 0, CTL_BYTES = 1 * MiB;
constexpr size_t WS_GARR = 1 * MiB, WS_AMAX = 1 * MiB + 8192, WS_MC = 1 * MiB + 16384;
constexpr size_t WS_WIN = 2 * MiB, WS_WOUT = 8 * MiB, WS_WFFN = 10 * MiB, WS_WFFN2 = 23 * MiB, WS_WP = 28 * MiB + 512 * 1024;
constexpr size_t WS_PB = 29 * MiB, WS_XNB = 37 * MiB, WS_HMIX = 69 * MiB;
constexpr size_t WS_UB = 101 * MiB, WS_QK = 197 * MiB, WS_ST = 229 * MiB;
constexpr size_t WS_HFF = 101 * MiB;
constexpr size_t WS_PP = 265 * MiB;
constexpr size_t WS_END = 297 * MiB;
constexpr int LDS_BYTES = 161792;

__device__ __forceinline__ float bf2f(bf16_t v) { return __uint_as_float((unsigned)v << 16); }
__device__ __forceinline__ float bflo(unsigned u) { return __uint_as_float(u << 16); }
__device__ __forceinline__ float bfhi(unsigned u) { return __uint_as_float(u & 0xffff0000u); }
__device__ __forceinline__ unsigned pk2(float lo, float hi) { f32x2 v = {lo, hi}; bf16x2_t b = __builtin_convertvector(v, bf16x2_t); return __builtin_bit_cast(unsigned, b); }
__device__ __forceinline__ float sigmoidf_(float x) { return 1.0f / (1.0f + __expf(-x)); }
#define LDS_WAIT() asm volatile("s_waitcnt lgkmcnt(0)" ::: "memory")

__device__ __forceinline__ bf16x8 frag_a(const LAS unsigned char* base, int pitchB, int c0, int k0, int lane) {
    return *(const LAS bf16x8*)(base + (c0 + (lane & 15)) * pitchB + (k0 + 8 * (lane >> 4)) * 2);
}
__device__ __forceinline__ bf16x8 frag_b(const LAS unsigned char* base, int pitchB, int c0, int k0, int lane) {
    const int i = lane & 15, g = lane >> 4;
    const LAS unsigned char* p = base + (k0 + 8 * g + (i >> 2)) * pitchB + (c0 + 4 * (i & 3)) * 2;
    const s16x4 lo = __builtin_bit_cast(s16x4, __builtin_amdgcn_ds_read_tr16_b64_v4i16((LAS s16x4*)p));
    const s16x4 hi = __builtin_bit_cast(s16x4, __builtin_amdgcn_ds_read_tr16_b64_v4i16((LAS s16x4*)(p + 4 * pitchB)));
    return (bf16x8){lo[0], lo[1], lo[2], lo[3], hi[0], hi[1], hi[2], hi[3]};
}
#define MFMA16(colsfrag, rowsfrag, acc) __builtin_amdgcn_mfma_f32_16x16x32_bf16((colsfrag), (rowsfrag), (acc), 0, 0, 0)

struct EpiStoreBf16 {
    static constexpr bool PERM = true, AFTER_DRAIN = false;
    bf16_t* O; int ldc;
    __device__ __forceinline__ void operator()(const f32x4 (&acc)[2][2][4][2], const pg8::Unit& u, int wr, int wc, int fr, int fq) const {
        const int row0 = u.pm * 256 + wr * 64 + fr, col0 = u.pn * 256 + wc * 32 + 8 * fq;
#pragma unroll
        for (int ai = 0; ai < 2; ++ai)
#pragma unroll
            for (int m = 0; m < 4; ++m) { bf16_t* rowp = O + (size_t)(row0 + ai * 128 + m * 16) * ldc + col0;
#pragma unroll
                for (int bj = 0; bj < 2; ++bj) { const f32x4 v0 = acc[ai][bj][m][0], v1 = acc[ai][bj][m][1];
                    u32x4 w; w.x = pk2(v0[0], v0[1]); w.y = pk2(v0[2], v0[3]); w.z = pk2(v1[0], v1[1]); w.w = pk2(v1[2], v1[3]);
                    *(u32x4*)(rowp + bj * 128) = w; } }
    }
};
struct EpiResid {
    static constexpr bool PERM = false, AFTER_DRAIN = false;
    const float* res; float* out; const bf16_t* ple;
    __device__ __forceinline__ void operator()(const f32x4 (&acc)[2][2][4][2], const pg8::Unit& u, int wr, int wc, int fr, int fq) const {
        const int row0 = u.pm * 256 + wr * 64 + fr, col0 = u.pn * 256 + wc * 32 + 4 * fq;
#pragma unroll
        for (int ai = 0; ai < 2; ++ai)
#pragma unroll
            for (int m = 0; m < 4; ++m) { const size_t off = (size_t)(row0 + ai * 128 + m * 16) * DM + col0;
#pragma unroll
                for (int bj = 0; bj < 2; ++bj)
#pragma unroll
                    for (int n = 0; n < 2; ++n) { const size_t o = off + bj * 128 + n * 16;
                        const f32x4 r = *(const f32x4*)(res + o); f32x4 v = acc[ai][bj][m][n] + ALPHA * r;
                        if (ple) { const u32x2 pw = *(const u32x2*)(ple + o); v[0] += bflo(pw.x); v[1] += bfhi(pw.x); v[2] += bflo(pw.y); v[3] += bfhi(pw.y); }
                        *(f32x4*)(out + o) = v; }
                asm volatile("" ::: "memory"); }
    }
};
struct EpiFfn {
    static constexpr bool PERM = true, AFTER_DRAIN = false;
    bf16_t* hff; bf16_t* pp;
    __device__ __forceinline__ void operator()(const f32x4 (&acc)[2][2][4][2], const pg8::Unit& u, int wr, int wc, int fr, int fq) const {
        const int row0 = u.pm * 256 + wr * 64 + fr;
        if (u.pn < 22) {
            const int col0 = u.pn * 128 + wc * 32 + 8 * fq;
#pragma unroll
            for (int ai = 0; ai < 2; ++ai)
#pragma unroll
                for (int m = 0; m < 4; ++m) { float hv[8];
#pragma unroll
                    for (int n = 0; n < 2; ++n)
#pragma unroll
                        for (int i = 0; i < 4; ++i) { const float gt = acc[ai][0][m][n][i], up = acc[ai][1][m][n][i]; hv[n * 4 + i] = gt * sigmoidf_(gt) * up; }
                    u32x4 w; w.x = pk2(hv[0], hv[1]); w.y = pk2(hv[2], hv[3]); w.z = pk2(hv[4], hv[5]); w.w = pk2(hv[6], hv[7]);
                    *(u32x4*)(hff + (size_t)(row0 + ai * 128 + m * 16) * DFF + col0) = w; }
        } else {
            const int col0 = (u.pn - 22) * 256 + wc * 32 + 8 * fq;
#pragma unroll
            for (int ai = 0; ai < 2; ++ai)
#pragma unroll
                for (int m = 0; m < 4; ++m)
#pragma unroll
                    for (int bj = 0; bj < 2; ++bj) { bf16_t* ptr = pp + (size_t)(row0 + ai * 128 + m * 16) * DM + col0 + bj * 128;
                        const u32x4 pw = *(const u32x4*)ptr; const f32x4 v0 = acc[ai][bj][m][0], v1 = acc[ai][bj][m][1];
                        u32x4 w; w.x = pk2(sigmoidf_(v0[0]) * bflo(pw.x), sigmoidf_(v0[1]) * bfhi(pw.x)); w.y = pk2(sigmoidf_(v0[2]) * bflo(pw.y), sigmoidf_(v0[3]) * bfhi(pw.y));
                        w.z = pk2(sigmoidf_(v1[0]) * bflo(pw.z), sigmoidf_(v1[1]) * bfhi(pw.z)); w.w = pk2(sigmoidf_(v1[2]) * bflo(pw.w), sigmoidf_(v1[3]) * bfhi(pw.w));
                        *(u32x4*)ptr = w; }
        }
    }
};

struct MapIn  { __device__ __forceinline__ int operator()(int n) const { return n < 2048 ? n : (n < 2816 ? n + 16 : (n < 2832 ? n - 768 : -1)); } };
struct MapId  { __device__ __forceinline__ int operator()(int n) const { return n; } };
struct MapFfn { __device__ __forceinline__ int operator()(int n) const { const int t = n >> 8, r = n & 255; return r < 128 ? 128 * t + r : 2816 + 128 * t + (r - 128); } };
template <class Map> __device__ __forceinline__ void transpose_item(const float* W, int K, int Nsrc, bf16_t* WT, LAS float* scr, int kb, int nb, int lane, Map map) {
    const int k0 = 64 * kb, n0 = 32 * nb;
    const int sc = map(n0 + (lane & 31));
#pragma unroll 8
    for (int i = 0; i < 32; ++i) { const int kk = 2 * i + (lane >> 5); scr[kk * 33 + (lane & 31)] = sc >= 0 ? W[(size_t)(k0 + kk) * Nsrc + sc] : 0.f; }
    LDS_WAIT();
    const int c = lane & 7;
#pragma unroll
    for (int j = 0; j < 4; ++j) { const int n = (lane >> 3) + 8 * j; const LAS float* s = scr + (8 * c) * 33 + n;
        u32x4 o; o.x = pk2(s[0 * 33], s[1 * 33]); o.y = pk2(s[2 * 33], s[3 * 33]); o.z = pk2(s[4 * 33], s[5 * 33]); o.w = pk2(s[6 * 33], s[7 * 33]);
        *(u32x4*)(WT + (size_t)(n0 + n) * K + k0 + 8 * c) = o; }
    LDS_WAIT();
}

struct Ctx {
    const float* in[17]; float* out; unsigned char* ws; LAS unsigned char* lds;
    int G, bx, vcu;
};
__device__ __forceinline__ int tid_opaque() { int t = threadIdx.x; asm volatile("" : "+v"(t)); return t; }
#define TID_ (tid_opaque())
#define LANE_ (tid_opaque() & 63)
#define WID_ (__builtin_amdgcn_readfirstlane(tid_opaque() >> 6))

__device__ __forceinline__ void cvt_rows(const Ctx& c, const float* src, bf16_t* dst, size_t n) {
    const size_t nthr = (size_t)c.G * NTHR;
    for (size_t i = (size_t)c.vcu * NTHR + TID_; i < n / 8; i += nthr) {
        const f32x4 a = *(const f32x4*)(src + i * 8), b = *(const f32x4*)(src + i * 8 + 4);
        u32x4 w; w.x = pk2(a[0], a[1]); w.y = pk2(a[2], a[3]); w.z = pk2(b[0], b[1]); w.w = pk2(b[2], b[3]);
        *(u32x4*)(dst + i * 8) = w;
    }
}

__device__ __forceinline__ void phase_cvt(const Ctx& c, int l) {
    LAS float* scr = (LAS float*)(c.lds + WID_ * 16384);
    const int gw = c.vcu * 8 + WID_, NGW = c.G * 8;
    const float* w_in = c.in[2] + (size_t)l * DM * NIN_SRC;
    const float* w_out = c.in[8] + (size_t)l * DM * DM;
    const float* w_ffn = c.in[11] + (size_t)l * DM * 2 * DFF;
    const float* w_ffn2 = c.in[12] + (size_t)l * DFF * DM;
    const float* w_g = c.in[15] + (size_t)l * DM * DM;
    const float* w_p = c.in[16] + (size_t)l * DPLE * DM;
    bf16_t* WIN = (bf16_t*)(c.ws + WS_WIN); bf16_t* WOUT = (bf16_t*)(c.ws + WS_WOUT); bf16_t* WFFN = (bf16_t*)(c.ws + WS_WFFN);
    bf16_t* WFFN2 = (bf16_t*)(c.ws + WS_WFFN2); bf16_t* WP = (bf16_t*)(c.ws + WS_WP);
    constexpr int I_IN = 16 * 96, I_OUT = 16 * 32, I_FFN = 16 * 176, I_G = 16 * 32, I_FFN2 = 44 * 32, I_P = 4 * 32;
    constexpr int NITEMS = I_IN + I_OUT + I_FFN + I_G + I_FFN2 + I_P;
    for (int it = gw; it < NITEMS; it += NGW) {
        int r = it;
        if (r < I_IN) { transpose_item(w_in, DM, NIN_SRC, WIN, scr, r / 96, r % 96, LANE_, MapIn()); continue; } r -= I_IN;
        if (r < I_OUT) { transpose_item(w_out, DM, DM, WOUT, scr, r / 32, r % 32, LANE_, MapId()); continue; } r -= I_OUT;
        if (r < I_FFN) { transpose_item(w_ffn, DM, 2 * DFF, WFFN, scr, r / 176, r % 176, LANE_, MapFfn()); continue; } r -= I_FFN;
        if (r < I_G) { transpose_item(w_g, DM, DM, WFFN + (size_t)2 * DFF * DM, scr, r / 32, r % 32, LANE_, MapId()); continue; } r -= I_G;
        if (r < I_FFN2) { transpose_item(w_ffn2, DFF, DM, WFFN2, scr, r / 32, r % 32, LANE_, MapId()); continue; } r -= I_FFN2;
        transpose_item(w_p, DPLE, DM, WP, scr, r / 32, r % 32, LANE_, MapId());
    }
    cvt_rows(c, c.in[1] + (size_t)l * MTOK * DPLE, (bf16_t*)(c.ws + WS_PB), (size_t)MTOK * DPLE);
    if (l == 0) cvt_rows(c, c.in[0], (bf16_t*)(c.ws + WS_XNB), (size_t)MTOK * DM);
}

__device__ __forceinline__ void phase_conv(const Ctx& c, int l) {
    const bf16_t* UB = (const bf16_t*)(c.ws + WS_UB); bf16_t* QK = (bf16_t*)(c.ws + WS_QK);
    const float* cw = c.in[4] + (size_t)l * 5 * DM; const float* cb = c.in[5] + (size_t)l * DM;
    const int nthr = c.G * NTHR;
    for (int item = c.vcu * NTHR + TID_; item < (MTOK / 16) * 128; item += nthr) {
        const int cg_ = item & 127, rb = item >> 7, ch = cg_ * 8, m0 = rb * 16, t0 = m0 & (SEQ - 1);
        float w[5][8], bias[8];
#pragma unroll
        for (int j = 0; j < 5; ++j) { const f32x4 a = *(const f32x4*)(cw + j * DM + ch), b = *(const f32x4*)(cw + j * DM + ch + 4);
            w[j][0] = a[0]; w[j][1] = a[1]; w[j][2] = a[2]; w[j][3] = a[3]; w[j][4] = b[0]; w[j][5] = b[1]; w[j][6] = b[2]; w[j][7] = b[3]; }
        { const f32x4 a = *(const f32x4*)(cb + ch), b = *(const f32x4*)(cb + ch + 4); bias[0] = a[0]; bias[1] = a[1]; bias[2] = a[2]; bias[3] = a[3]; bias[4] = b[0]; bias[5] = b[1]; bias[6] = b[2]; bias[7] = b[3]; }
        const float scale = ch >= 512 ? 0.08838834764831845f : 1.0f;
        u32x4 win[5];
        const u32x4 z = {0u, 0u, 0u, 0u};
        win[0] = z; win[1] = z;
        if (t0 >= 2) { win[0] = *(const u32x4*)(UB + (size_t)(m0 - 2) * NIN + ch); win[1] = *(const u32x4*)(UB + (size_t)(m0 - 1) * NIN + ch); }
        win[2] = *(const u32x4*)(UB + (size_t)(m0) * NIN + ch); win[3] = *(const u32x4*)(UB + (size_t)(m0 + 1) * NIN + ch);
#pragma unroll
        for (int r = 0; r < 16; ++r) {
            if (r + 2 < 16 || t0 + 16 < SEQ) win[4] = *(const u32x4*)(UB + (size_t)(m0 + r + 2) * NIN + ch); else win[4] = z;
            float acc[8];
#pragma unroll
            for (int i = 0; i < 8; ++i) acc[i] = bias[i];
#pragma unroll
            for (int j = 0; j < 5; ++j) {
                acc[0] += w[j][0] * bflo(win[j].x); acc[1] += w[j][1] * bfhi(win[j].x); acc[2] += w[j][2] * bflo(win[j].y); acc[3] += w[j][3] * bfhi(win[j].y);
                acc[4] += w[j][4] * bflo(win[j].z); acc[5] += w[j][5] * bfhi(win[j].z); acc[6] += w[j][6] * bflo(win[j].w); acc[7] += w[j][7] * bfhi(win[j].w);
            }
#pragma unroll
            for (int i = 0; i < 8; ++i) acc[i] = acc[i] * sigmoidf_(acc[i]) * scale;
            u32x4 o; o.x = pk2(acc[0], acc[1]); o.y = pk2(acc[2], acc[3]); o.z = pk2(acc[4], acc[5]); o.w = pk2(acc[6], acc[7]);
            *(u32x4*)(QK + (size_t)(m0 + r) * DM + ch) = o;
            win[0] = win[1]; win[1] = win[2]; win[2] = win[3]; win[3] = win[4];
        }
    }
}

__device__ __forceinline__ void gate_prep(int dir, const bf16_t* UB, size_t m0, int h, const float* bg, LAS unsigned char* ga, int lane, float& g_out, float& cmfull_out) {
    LAS float* BT = (LAS float*)(ga) + dir * LCH; LAS float* CS = (LAS float*)(ga + 1024) + dir * LCH;
    LAS float* CM = (LAS float*)(ga + 2048) + dir * LCH; LAS float* WA = (LAS float*)(ga + 3072) + dir * LCH;
    const int icol = (dir ? 4 : 0) + h, fcol = 8 + (dir ? 4 : 0) + h;
    const float bi = bg[icol], bfv = bg[fcol];
    float iv[2], lf[2]; int tt[2];
#pragma unroll
    for (int e = 0; e < 2; ++e) { const int u = 2 * lane + e, t = dir ? (LCH - 1 - u) : u; tt[e] = t;
        const bf16_t* r = UB + (m0 + t) * NIN + C_G;
        iv[e] = bf2f(r[icol]) + bi; const float f = bf2f(r[fcol]) + bfv;
        lf[e] = fminf(f, 0.f) - log1pf(__expf(-fabsf(f))); }
    const float y1 = lf[0] + lf[1];
    float T = y1;
#pragma unroll
    for (int o = 1; o < 64; o <<= 1) { const float v = __shfl_up(T, o); if (lane >= o) T += v; }
    const float ex = T - y1, b0 = ex + lf[0], b1 = ex + y1;
    const float c0 = iv[0] - b0, c1 = iv[1] - b1;
    float Mx = fmaxf(c0, c1);
#pragma unroll
    for (int o = 1; o < 64; o <<= 1) { const float v = __shfl_up(Mx, o); if (lane >= o) Mx = fmaxf(Mx, v); }
    float exM = __shfl_up(Mx, 1); if (lane == 0) exM = -INFINITY;
    const float cm0 = fmaxf(exM, c0), cm1 = Mx;
    const float g = __shfl(T, 63), cmf = __shfl(Mx, 63);
    BT[tt[0]] = b0; BT[tt[1]] = b1; CS[tt[0]] = c0; CS[tt[1]] = c1; CM[tt[0]] = cm0; CM[tt[1]] = cm1;
    WA[tt[0]] = __expf(c0 - cmf); WA[tt[1]] = __expf(c1 - cmf);
    g_out = g; cmfull_out = cmf;
}

__device__ __forceinline__ void m1_unit(const Ctx& c, int l, int unit) {
    const int ch = unit & (NCH - 1), bh = unit / NCH, h = bh & 3, b = bh >> 2;
    const size_t m0 = (size_t)b * SEQ + (size_t)ch * LCH;
    const bf16_t* UB = (const bf16_t*)(c.ws + WS_UB); const bf16_t* QK = (const bf16_t*)(c.ws + WS_QK);
    bf16_t* ST = (bf16_t*)(c.ws + WS_ST); float* GARR = (float*)(c.ws + WS_GARR); float* AMAX = (float*)(c.ws + WS_AMAX);
    LAS unsigned char* KS = c.lds; LAS unsigned char* VF = c.lds + 34816; LAS unsigned char* VB = c.lds + 73728; LAS unsigned char* GA = c.lds + 112640;
    const int lane = LANE_, wid = WID_, tid = TID_;
    if (wid < 2) { float g, cmf; gate_prep(wid, UB, m0, h, c.in[3] + l * 16, GA, lane, g, cmf);
        if (lane == 0) { const int chain = wid * 16 + b * 4 + h; GARR[chain * NCH + ch] = g; AMAX[chain * NCH + ch] = g + cmf; } }
#pragma unroll
    for (int it = 0; it < 4; ++it) { const int idx = tid + it * NTHR, s = idx >> 4, cc = idx & 15;
        *(LAS u32x4*)(KS + s * 272 + cc * 16) = *(const u32x4*)(QK + (m0 + s) * DM + 512 + h * 128 + cc * 8); }
    __syncthreads();
    const LAS float* WAf = (const LAS float*)(GA + 3072); const LAS float* WAb = WAf + LCH;
    for (int idx = tid; idx < LCH * 18; idx += NTHR) { const int s = idx / 18, cc = idx - s * 18; const float wf = WAf[s], wb = WAb[s];
        u32x4 of, ob;
        if (cc < 16) { const u32x4 v = *(const u32x4*)(UB + (m0 + s) * NIN + C_V + h * 128 + cc * 8);
            of.x = pk2(bflo(v.x) * wf, bfhi(v.x) * wf); of.y = pk2(bflo(v.y) * wf, bfhi(v.y) * wf); of.z = pk2(bflo(v.z) * wf, bfhi(v.z) * wf); of.w = pk2(bflo(v.w) * wf, bfhi(v.w) * wf);
            ob.x = pk2(bflo(v.x) * wb, bfhi(v.x) * wb); ob.y = pk2(bflo(v.y) * wb, bfhi(v.y) * wb); ob.z = pk2(bflo(v.z) * wb, bfhi(v.z) * wb); ob.w = pk2(bflo(v.w) * wb, bfhi(v.w) * wb);
        } else if (cc == 16) { of = (u32x4){pk2(wf, 0.f), 0u, 0u, 0u}; ob = (u32x4){pk2(wb, 0.f), 0u, 0u, 0u}; }
        else { of = (u32x4){0u, 0u, 0u, 0u}; ob = of; }
        *(LAS u32x4*)(VF + s * 304 + cc * 16) = of; *(LAS u32x4*)(VB + s * 304 + cc * 16) = ob; }
    __syncthreads();
    const int d0 = 16 * wid, fq = lane >> 4, fr = lane & 15;
    f32x4 acc[2][9];
#pragma unroll
    for (int i = 0; i < 9; ++i) { acc[0][i] = (f32x4){0.f, 0.f, 0.f, 0.f}; acc[1][i] = (f32x4){0.f, 0.f, 0.f, 0.f}; }
#pragma unroll
    for (int ks = 0; ks < 4; ++ks) { const bf16x8 kb = frag_b(KS, 272, d0, 32 * ks, lane);
#pragma unroll
        for (int i = 0; i < 9; ++i) { const bf16x8 vf = frag_b(VF, 304, 16 * i, 32 * ks, lane), vb = frag_b(VB, 304, 16 * i, 32 * ks, lane);
            acc[0][i] = MFMA16(kb, vf, acc[0][i]); acc[1][i] = MFMA16(kb, vb, acc[1][i]); } }
#pragma unroll
    for (int dir = 0; dir < 2; ++dir) { bf16_t* tile = ST + ((size_t)((dir * 16 + b * 4 + h) * NCH + ch)) * ST_TILE;
#pragma unroll
        for (int i = 0; i < 9; ++i) { u32x2 w; w.x = pk2(acc[dir][i][0], acc[dir][i][1]); w.y = pk2(acc[dir][i][2], acc[dir][i][3]);
            *(u32x2*)(tile + (16 * i + fr) * 128 + d0 + 4 * fq) = w; } }
    __syncthreads();
}

__device__ __forceinline__ void attn_unit(const Ctx& c, int l, int unit) {
    const int n = unit & 31, kvh = (unit >> 5) & 1, b = unit >> 6;
    const bf16_t* UB = (const bf16_t*)(c.ws + WS_UB); bf16_t* HMIX = (bf16_t*)(c.ws + WS_HMIX);
    LAS unsigned char* K3 = c.lds; LAS unsigned char* V3 = c.lds + 55296; LAS unsigned char* PBUF = c.lds + 110592 + WID_ * 4352;
    const int lane = LANE_, wid = WID_, tid = TID_, fq = lane >> 4, fr = lane & 15;
    for (int idx = tid; idx < 384 * 8; idx += NTHR) { const int j = idx >> 3, cc = idx & 7, kpos = 128 * (n - 1) + j;
        u32x4 kv = {0u, 0u, 0u, 0u}, vv = {0u, 0u, 0u, 0u};
        if (kpos >= 0 && kpos < SEQ) { const bf16_t* r = UB + ((size_t)b * SEQ + kpos) * NIN; kv = *(const u32x4*)(r + C_AK + kvh * 64 + cc * 8); vv = *(const u32x4*)(r + C_AV + kvh * 64 + cc * 8); }
        *(LAS u32x4*)(K3 + j * 144 + cc * 16) = kv; *(LAS u32x4*)(V3 + j * 144 + cc * 16) = vv; }
    __syncthreads();
    const int g = wid >> 1, rh = wid & 1, hq = kvh * 4 + g;
    const float slope = exp2f(-(float)(hq + 1)), sink = c.in[7][l * 8 + hq];
    for (int strip = 0; strip < 4; ++strip) {
        const int t0 = rh * 64 + strip * 16, tq = t0 + fr;
        const size_t row = (size_t)b * SEQ + 128 * n + tq;
        const bf16_t* qp = UB + row * NIN + C_AQ + hq * 64 + 8 * fq;
        const bf16x8 qa0 = *(const bf16x8*)(qp), qa1 = *(const bf16x8*)(qp + 32);
        f32x4 sc[24];
#pragma unroll
        for (int n2 = 0; n2 < 24; ++n2) { sc[n2] = (f32x4){0.f, 0.f, 0.f, 0.f};
            sc[n2] = MFMA16(frag_a(K3, 144, 16 * n2, 0, lane), qa0, sc[n2]); sc[n2] = MFMA16(frag_a(K3, 144, 16 * n2, 32, lane), qa1, sc[n2]); }
        float mx = -INFINITY;
#pragma unroll
        for (int n2 = 0; n2 < 24; ++n2)
#pragma unroll
            for (int r = 0; r < 4; ++r) { const int j = 16 * n2 + 4 * fq + r, rel = j - 128 - tq, arel = rel < 0 ? -rel : rel;
                const bool valid = (arel <= 128) && (n > 0 || j >= 128) && (n < 31 || j < 256);
                const float s = valid ? sc[n2][r] * 0.125f - slope * (float)arel : -INFINITY; sc[n2][r] = s; mx = fmaxf(mx, s); }
        mx = fmaxf(mx, __shfl_xor(mx, 16)); mx = fmaxf(mx, __shfl_xor(mx, 32)); mx = fmaxf(mx, sink);
        float sum = 0.f;
#pragma unroll
        for (int n2 = 0; n2 < 24; ++n2)
#pragma unroll
            for (int r = 0; r < 4; ++r) { const float e = __expf(sc[n2][r] - mx); sc[n2][r] = e; sum += e; }
        sum += __shfl_xor(sum, 16); sum += __shfl_xor(sum, 32);
        const float inv = 1.0f / (sum + __expf(sink - mx));
        f32x4 o[4];
#pragma unroll
        for (int ne = 0; ne < 4; ++ne) o[ne] = (f32x4){0.f, 0.f, 0.f, 0.f};
#pragma unroll
        for (int kb = 0; kb < 3; ++kb) {
#pragma unroll
            for (int n2 = 0; n2 < 8; ++n2) { const f32x4 e = sc[kb * 8 + n2]; u32x2 w; w.x = pk2(e[0] * inv, e[1] * inv); w.y = pk2(e[2] * inv, e[3] * inv);
                *(LAS u32x2*)(PBUF + fr * 272 + (16 * n2 + 4 * fq) * 2) = w; }
            LDS_WAIT();
#pragma unroll
            for (int ks = 0; ks < 4; ++ks) { const bf16x8 pa = frag_a(PBUF, 272, 0, 32 * ks, lane);
#pragma unroll
                for (int ne = 0; ne < 4; ++ne) o[ne] = MFMA16(frag_b(V3, 144, 16 * ne, 128 * kb + 32 * ks, lane), pa, o[ne]); }
            LDS_WAIT();
        }
        bf16_t* op = HMIX + row * DM + 512 + hq * 64 + 4 * fq;
#pragma unroll
        for (int ne = 0; ne < 4; ++ne) { u32x2 w; w.x = pk2(o[ne][0], o[ne][1]); w.y = pk2(o[ne][2], o[ne][3]); *(u32x2*)(op + 16 * ne) = w; }
    }
    __syncthreads();
}

__device__ __forceinline__ void phase_m2(const Ctx& c) {
    bf16_t* ST = (bf16_t*)(c.ws + WS_ST); const float* GARR = (const float*)(c.ws + WS_GARR); const float* AMAX = (const float*)(c.ws + WS_AMAX); float* MC = (float*)(c.ws + WS_MC);
    for (int w = c.vcu; w < 256; w += c.G) {
        const int chain = w >> 3, part = w & 7, dir = chain >> 4;
        if (TID_ < 288) {
            const int j = part * 288 + TID_;
            bf16_t* base = ST + (size_t)chain * NCH * ST_TILE + (size_t)j * 8;
            u32x4 buf[NCH];
#pragma unroll
            for (int s = 0; s < NCH; ++s) { const int cc = dir ? (NCH - 1 - s) : s; buf[s] = *(const u32x4*)(base + (size_t)cc * ST_TILE); }
            float R[8]; float m = 0.f;
#pragma unroll
            for (int i = 0; i < 8; ++i) R[i] = 0.f;
#pragma unroll
            for (int s = 0; s < NCH; ++s) { const int cc = dir ? (NCH - 1 - s) : s;
                const float g = GARR[chain * NCH + cc], am = AMAX[chain * NCH + cc];
                u32x4 o; o.x = pk2(R[0], R[1]); o.y = pk2(R[2], R[3]); o.z = pk2(R[4], R[5]); o.w = pk2(R[6], R[7]);
                *(u32x4*)(base + (size_t)cc * ST_TILE) = o;
                if (j == 0) MC[chain * NCH + cc] = m;
                const float mn = fmaxf(g + m, am), dcy = __expf(g + m - mn), scl = __expf(am - mn);
                const u32x4 u = buf[s];
                R[0] = dcy * R[0] + scl * bflo(u.x); R[1] = dcy * R[1] + scl * bfhi(u.x); R[2] = dcy * R[2] + scl * bflo(u.y); R[3] = dcy * R[3] + scl * bfhi(u.y);
                R[4] = dcy * R[4] + scl * bflo(u.z); R[5] = dcy * R[5] + scl * bfhi(u.z); R[6] = dcy * R[6] + scl * bflo(u.w); R[7] = dcy * R[7] + scl * bfhi(u.w);
                m = mn; }
        }
    }
}

__device__ __forceinline__ void m3_unit(const Ctx& c, int l, int unit) {
    const int ch = unit & (NCH - 1), bh = unit / NCH, h = bh & 3, b = bh >> 2;
    const size_t m0 = (size_t)b * SEQ + (size_t)ch * LCH;
    const bf16_t* UB = (const bf16_t*)(c.ws + WS_UB); const bf16_t* QK = (const bf16_t*)(c.ws + WS_QK);
    const bf16_t* ST = (const bf16_t*)(c.ws + WS_ST); const float* MC = (const float*)(c.ws + WS_MC); bf16_t* HMIX = (bf16_t*)(c.ws + WS_HMIX);
    LAS unsigned char* QS = c.lds; LAS unsigned char* RA = c.lds + 34816; LAS unsigned char* RB = c.lds + 73984; LAS unsigned char* RC = c.lds + 113152; LAS unsigned char* GA = c.lds + 152320;
    const int lane = LANE_, wid = WID_, tid = TID_, fq = lane >> 4, fr = lane & 15;
    const int chain_f = b * 4 + h, chain_b = 16 + b * 4 + h;
    if (wid < 2) { float g, cmf; gate_prep(wid, UB, m0, h, c.in[3] + l * 16, GA, lane, g, cmf); }
#pragma unroll
    for (int it = 0; it < 4; ++it) { const int idx = tid + it * NTHR, s = idx >> 4, cc = idx & 15;
        *(LAS u32x4*)(QS + s * 272 + cc * 16) = *(const u32x4*)(QK + (m0 + s) * DM + h * 128 + cc * 8);
        *(LAS u32x4*)(RA + s * 272 + cc * 16) = *(const u32x4*)(QK + (m0 + s) * DM + 512 + h * 128 + cc * 8); }
    for (int idx = tid; idx < LCH * 18; idx += NTHR) { const int s = idx / 18, cc = idx - s * 18;
        u32x4 v;
        if (cc < 16) v = *(const u32x4*)(UB + (m0 + s) * NIN + C_V + h * 128 + cc * 8);
        else if (cc == 16) v = (u32x4){0x00003F80u, 0u, 0u, 0u};
        else v = (u32x4){0u, 0u, 0u, 0u};
        *(LAS u32x4*)(RC + s * 304 + cc * 16) = v; }
    __syncthreads();
    const int r0 = 16 * wid, t = r0 + fr;
    const LAS float* BTf = (const LAS float*)(GA); const LAS float* BTb = BTf + LCH;
    const LAS float* CSf = (const LAS float*)(GA + 1024); const LAS float* CSb = CSf + LCH;
    const LAS float* CMf = (const LAS float*)(GA + 2048); const LAS float* CMb = CMf + LCH;
    const float mcf = MC[chain_f * NCH + ch], mcb = MC[chain_b * NCH + ch];
    const float Mf = fmaxf(CMf[t], mcf), Mb = fmaxf(CMb[t], mcb);
    const float winf = __expf(mcf - Mf), winb = __expf(mcb - Mb);
    const float flf = __expf(-BTf[t] - Mf), flb = __expf(-BTb[t] - Mb);
    f32x4 sa[8];
#pragma unroll
    for (int n = 0; n < 8; ++n) sa[n] = (f32x4){0.f, 0.f, 0.f, 0.f};
#pragma unroll
    for (int ks = 0; ks < 4; ++ks) { const bf16x8 qa = frag_a(QS, 272, r0, 32 * ks, lane);
#pragma unroll
        for (int n = 0; n < 8; ++n) sa[n] = MFMA16(frag_a(RA, 272, 16 * n, 32 * ks, lane), qa, sa[n]); }
    __syncthreads();
#pragma unroll
    for (int n = 0; n < 8; ++n) { const int s0 = 16 * n + 4 * fq;
        const f32x4 cf = *(const LAS f32x4*)(CSf + s0), cbv = *(const LAS f32x4*)(CSb + s0);
        float pf[4], pb[4];
#pragma unroll
        for (int r = 0; r < 4; ++r) { const int s = s0 + r; const float sv = sa[n][r];
            pf[r] = (s <= t) ? sv * __expf(cf[r] - Mf) : 0.f; pb[r] = (s >= t) ? sv * __expf(cbv[r] - Mb) : 0.f; }
        u32x2 wf, wb; wf.x = pk2(pf[0], pf[1]); wf.y = pk2(pf[2], pf[3]); wb.x = pk2(pb[0], pb[1]); wb.y = pk2(pb[2], pb[3]);
        *(LAS u32x2*)(RA + t * 272 + s0 * 2) = wf; *(LAS u32x2*)(RB + t * 272 + s0 * 2) = wb; }
    LDS_WAIT();
    f32x4 af[9], ab[9];
#pragma unroll
    for (int n = 0; n < 9; ++n) { af[n] = (f32x4){0.f, 0.f, 0.f, 0.f}; ab[n] = (f32x4){0.f, 0.f, 0.f, 0.f}; }
#pragma unroll
    for (int ks = 0; ks < 4; ++ks) { const bf16x8 pf = frag_a(RA, 272, r0, 32 * ks, lane), pb = frag_a(RB, 272, r0, 32 * ks, lane);
#pragma unroll
        for (int n = 0; n < 9; ++n) { const bf16x8 vb = frag_b(RC, 304, 16 * n, 32 * ks, lane); af[n] = MFMA16(vb, pf, af[n]); ab[n] = MFMA16(vb, pb, ab[n]); } }
    __syncthreads();
    { const bf16_t* cfp = ST + (size_t)(chain_f * NCH + ch) * ST_TILE; const bf16_t* cbp = ST + (size_t)(chain_b * NCH + ch) * ST_TILE;
        for (int idx = tid; idx < ST_E * 16; idx += NTHR) { const int e = idx >> 4, cc = idx & 15;
            *(LAS u32x4*)(RA + e * 272 + cc * 16) = *(const u32x4*)(cfp + e * 128 + cc * 8);
            *(LAS u32x4*)(RB + e * 272 + cc * 16) = *(const u32x4*)(cbp + e * 128 + cc * 8); } }
    __syncthreads();
    {
        f32x4 a2[9];
#pragma unroll
        for (int n = 0; n < 9; ++n) a2[n] = (f32x4){0.f, 0.f, 0.f, 0.f};
#pragma unroll
        for (int ks = 0; ks < 4; ++ks) { const bf16x8 qa = frag_a(QS, 272, r0, 32 * ks, lane);
#pragma unroll
            for (int n = 0; n < 9; ++n) a2[n] = MFMA16(frag_a(RA, 272, 16 * n, 32 * ks, lane), qa, a2[n]); }
#pragma unroll
        for (int n = 0; n < 9; ++n) af[n] += winf * a2[n];
#pragma unroll
        for (int n = 0; n < 9; ++n) a2[n] = (f32x4){0.f, 0.f, 0.f, 0.f};
#pragma unroll
        for (int ks = 0; ks < 4; ++ks) { const bf16x8 qa = frag_a(QS, 272, r0, 32 * ks, lane);
#pragma unroll
            for (int n = 0; n < 9; ++n) a2[n] = MFMA16(frag_a(RB, 272, 16 * n, 32 * ks, lane), qa, a2[n]); }
#pragma unroll
        for (int n = 0; n < 9; ++n) ab[n] += winb * a2[n];
    }
    const float denf = __shfl(af[8][0], fr), denb = __shfl(ab[8][0], fr);
    const float invf = 1.0f / fmaxf(fabsf(denf), flf), invb = 1.0f / fmaxf(fabsf(denb), flb);
    float hsum = 0.f;
#pragma unroll
    for (int n = 0; n < 8; ++n)
#pragma unroll
        for (int r = 0; r < 4; ++r) { const float hv = af[n][r] * invf + ab[n][r] * invb; af[n][r] = hv; hsum += hv; }
    hsum += __shfl_xor(hsum, 16); hsum += __shfl_xor(hsum, 32);
    const float mu = hsum * (1.0f / 128.0f);
    float vs = 0.f;
#pragma unroll
    for (int n = 0; n < 8; ++n)
#pragma unroll
        for (int r = 0; r < 4; ++r) { const float dlt = af[n][r] - mu; vs += dlt * dlt; }
    vs += __shfl_xor(vs, 16); vs += __shfl_xor(vs, 32);
    const float rstd = rsqrtf(vs * (1.0f / 128.0f) + MH_EPS);
    const float* ng = c.in[6] + l * 512 + h * 128;
    const bf16_t* og = UB + (m0 + t) * NIN + C_O + h * 128;
    bf16_t* hp = HMIX + (m0 + t) * DM + h * 128;
#pragma unroll
    for (int n = 0; n < 8; ++n) { const int e0 = 16 * n + 4 * fq;
        const f32x4 g4 = *(const f32x4*)(ng + e0); const u32x2 ow = *(const u32x2*)(og + e0);
        const float v0 = (af[n][0] - mu) * rstd * g4[0] * sigmoidf_(bflo(ow.x)), v1 = (af[n][1] - mu) * rstd * g4[1] * sigmoidf_(bfhi(ow.x));
        const float v2 = (af[n][2] - mu) * rstd * g4[2] * sigmoidf_(bflo(ow.y)), v3 = (af[n][3] - mu) * rstd * g4[3] * sigmoidf_(bfhi(ow.y));
        u32x2 w; w.x = pk2(v0, v1); w.y = pk2(v2, v3); *(u32x2*)(hp + e0) = w; }
    __syncthreads();
}

__device__ __forceinline__ void phase_ln(const Ctx& c, const float* gam, const float* bet) {
    float* X = c.out; bf16_t* XNB = (bf16_t*)(c.ws + WS_XNB);
    const int gw = c.vcu * 8 + WID_, NGW = c.G * 8;
    f32x4 gv[4], bv[4];
#pragma unroll
    for (int j = 0; j < 4; ++j) { gv[j] = *(const f32x4*)(gam + 4 * LANE_ + 256 * j); bv[j] = *(const f32x4*)(bet + 4 * LANE_ + 256 * j); }
    for (int m = gw; m < MTOK; m += NGW) {
        float* xr = X + (size_t)m * DM + 4 * LANE_;
        f32x4 v[4]; float s = 0.f;
#pragma unroll
        for (int j = 0; j < 4; ++j) { v[j] = *(const f32x4*)(xr + 256 * j); s += (v[j][0] + v[j][1]) + (v[j][2] + v[j][3]); }
#pragma unroll
        for (int o = 1; o < 64; o <<= 1) s += __shfl_xor(s, o);
        const float mean = s * (1.0f / DM); float s2 = 0.f;
#pragma unroll
        for (int j = 0; j < 4; ++j) { v[j] = v[j] - mean; s2 += (v[j][0] * v[j][0] + v[j][1] * v[j][1]) + (v[j][2] * v[j][2] + v[j][3] * v[j][3]); }
#pragma unroll
        for (int o = 1; o < 64; o <<= 1) s2 += __shfl_xor(s2, o);
        const float rstd = rsqrtf(s2 * (1.0f / DM) + LN_EPS);
        bf16_t* br = XNB + (size_t)m * DM + 4 * LANE_;
#pragma unroll
        for (int j = 0; j < 4; ++j) { const f32x4 y = v[j] * rstd * gv[j] + bv[j]; *(f32x4*)(xr + 256 * j) = y;
            u32x2 w; w.x = pk2(y[0], y[1]); w.y = pk2(y[2], y[3]); *(u32x2*)(br + 256 * j) = w; }
    }
}

struct Args { const float* in[17]; float* out; unsigned char* ws; int ph_lo, ph_hi; };

__global__ void __launch_bounds__(NTHR, 2) mk_fwd(Args a) {
    extern __shared__ __attribute__((aligned(16))) unsigned char lds_raw[];
    Ctx c;
#pragma unroll
    for (int i = 0; i < 17; ++i) c.in[i] = a.in[i];
    c.out = a.out; c.ws = a.ws; c.lds = (LAS unsigned char*)lds_raw;
    c.G = gridDim.x; c.bx = blockIdx.x; c.vcu = (c.G % 8 == 0) ? (c.bx % 8) * (c.G / 8) + c.bx / 8 : c.bx;
    const bf16_t* XNB = (const bf16_t*)(a.ws + WS_XNB);
    for (int ph = a.ph_lo; ph < a.ph_hi; ++ph) {
        const int l = ph / NSTAGE, st = ph - l * NSTAGE;
        if (st == 0) { if (ST_ON(0)) phase_cvt(c, l); }
        else if (st == 1) { if (ST_ON(1)) {
            for (int sub = 0; sub < 2; ++sub) {
                pg8::Gemm g; EpiStoreBf16 E;
                if (sub == 0) { g = pg8::Gemm{XNB, (const bf16_t*)(a.ws + WS_WIN), MTOK, NIN, DM}; E = EpiStoreBf16{(bf16_t*)(a.ws + WS_UB), NIN}; }
                else { g = pg8::Gemm{(const bf16_t*)(a.ws + WS_PB), (const bf16_t*)(a.ws + WS_WP), MTOK, DM, DPLE}; E = EpiStoreBf16{(bf16_t*)(a.ws + WS_PP), DM}; }
                pg8::StaticOrder S; S.init(MTOK, g.N, c.G, c.bx);
                pg8::gemm_phase<EpiStoreBf16, pg8::StaticOrder, true, true>(c.lds, g, S, E);
            }
        } }
        else if (st == 2) { if (ST_ON(2)) phase_conv(c, l); }
        else if (st == 3) { if (ST_ON(3)) {
            for (int u = c.vcu; u < NB * 4 * NCH; u += c.G) m1_unit(c, l, u);
            for (int u = c.vcu; u < NB * 2 * 32; u += c.G) attn_unit(c, l, u);
        } }
        else if (st == 4) { if (ST_ON(4)) phase_m2(c); }
        else if (st == 5) { if (ST_ON(5)) { for (int u = c.vcu; u < NB * 4 * NCH; u += c.G) m3_unit(c, l, u); } }
        else if (st == 6 || st == 9) { if (ST_ON(6)) {
            pg8::Gemm g; EpiResid E;
            if (st == 6) { g = pg8::Gemm{(const bf16_t*)(a.ws + WS_HMIX), (const bf16_t*)(a.ws + WS_WOUT), MTOK, DM, DM}; E = EpiResid{l == 0 ? a.in[0] : (const float*)a.out, a.out, nullptr}; }
            else { g = pg8::Gemm{(const bf16_t*)(a.ws + WS_HFF), (const bf16_t*)(a.ws + WS_WFFN2), MTOK, DM, DFF}; E = EpiResid{(const float*)a.out, a.out, (const bf16_t*)(a.ws + WS_PP)}; }
            pg8::StaticOrder S; S.init(MTOK, DM, c.G, c.bx);
            pg8::gemm_phase<EpiResid, pg8::StaticOrder, true, true>(c.lds, g, S, E);
        } }
        else if (st == 7) { if (ST_ON(7)) phase_ln(c, a.in[9] + l * DM, a.in[10] + l * DM); }
        else if (st == 8) { if (ST_ON(8)) {
            pg8::Gemm g{XNB, (const bf16_t*)(a.ws + WS_WFFN), MTOK, NFFN, DM}; pg8::StaticOrder S; S.init(MTOK, NFFN, c.G, c.bx);
            EpiFfn E{(bf16_t*)(a.ws + WS_HFF), (bf16_t*)(a.ws + WS_PP)};
            pg8::gemm_phase<EpiFfn, pg8::StaticOrder, true, true>(c.lds, g, S, E);
        } }
        else { if (ST_ON(10)) phase_ln(c, a.in[13] + l * DM, a.in[14] + l * DM); }
#if ONE_LAUNCH
        if (ph + 1 < a.ph_hi) { __threadfence(); cg::this_grid().sync(); }
#endif
    }
}

extern "C" void kernel_launch(void* const* d_in, const int* in_sizes, int n_in, void* d_out, int out_size, void* d_ws, size_t ws_size, hipStream_t stream) {
    static int grid = 0;
    if (grid == 0) {
        if (n_in != 17 || out_size != MTOK * DM || ws_size < WS_END) { fprintf(stderr, "kernel_launch: unexpected problem (n_in %d, out %d, ws %zu)\n", n_in, out_size, ws_size); grid = -1; return; }
        int dev = 0, cus = 0, per_cu = 0;
        hipGetDevice(&dev); hipDeviceGetAttribute(&cus, hipDeviceAttributeMultiprocessorCount, dev);
        hipFuncSetAttribute((const void*)mk_fwd, hipFuncAttributeMaxDynamicSharedMemorySize, LDS_BYTES);
        hipOccupancyMaxActiveBlocksPerMultiprocessor(&per_cu, (const void*)mk_fwd, NTHR, LDS_BYTES);
        (void)hipGetLastError();
        if (per_cu < 1) { fprintf(stderr, "kernel_launch: occupancy query says %d blocks per CU\n", per_cu); per_cu = 1; }
        grid = cus;
    }
    if (grid < 0) return;
    Args a{};
    for (int i = 0; i < 17; ++i) a.in[i] = (const float*)d_in[i];
    a.out = (float*)d_out; a.ws = (unsigned char*)d_ws;
#if ONE_LAUNCH
    a.ph_lo = 0; a.ph_hi = NPHASE;
    void* args[] = {&a};
    hipError_t e = hipLaunchCooperativeKernel((const void*)mk_fwd, dim3(grid), dim3(NTHR), args, LDS_BYTES, stream);
    if (e != hipSuccess) fprintf(stderr, "cooperative launch failed: %s (grid %d)\n", hipGetErrorString(e), grid);
#else
    for (int ph = 0; ph < NPHASE; ++ph) { a.ph_lo = ph; a.ph_hi = ph + 1; hipLaunchKernelGGL(mk_fwd, dim3(grid), dim3(NTHR), LDS_BYTES, stream, a); }
#endif
}
```
